# Optimizing an MI355X kernel written in HIP

```python
import math
import jax, jax.numpy as jnp
from jax import lax
import numpy as np

D_MODEL = 1024
BATCH = 4
SEQ = 4096
DEPTH = 1

HEAD_DIM = 64
D_MIX = D_MODEL
D_SB = D_MIX // 2
D_MB = D_MIX - D_SB
N_HEADS_SB = D_SB // HEAD_DIM
N_HEADS_MB = D_MB // HEAD_DIM
Q_BLOCK = 128
MOBA_BLOCK = 256
MOBA_TOPK = 3
N_BUCKETS = 32
MAX_DISTANCE = 128
D_FF = -(-8 * D_MODEL // (3 * 256)) * 256
LN_EPS = 1e-5
RMS_EPS = 1e-6
DN_ALPHA = (2 * DEPTH) ** 0.25
DN_BETA = (8 * DEPTH) ** -0.25
NEG_INF = -jnp.inf

kernel_name = 'hybrid_stickbreak_moba_deepnorm_adaln'


def layer_norm(x, g, b):
    xf = x.astype(jnp.float32)
    mu = jnp.mean(xf, axis=-1, keepdims=True)
    var = jnp.mean(jnp.square(xf - mu), axis=-1, keepdims=True)
    return ((xf - mu) * lax.rsqrt(var + LN_EPS) * g + b).astype(x.dtype)


def split_heads(t, n_heads):
    b, s, _ = t.shape
    return t.reshape(b, s, n_heads, HEAD_DIM).transpose(0, 2, 1, 3)


def head_rms_merge(o, g):
    o = o * lax.rsqrt(jnp.mean(jnp.square(o), axis=-1, keepdims=True) + RMS_EPS)
    b, h, s, d = o.shape
    return o.transpose(0, 2, 1, 3).reshape(b, s, h * d) * g


def t5_bucket(dist):
    n = jnp.maximum(dist, 0)
    max_exact = N_BUCKETS // 2
    nf = jnp.maximum(n, 1).astype(jnp.float32)
    large = max_exact + (jnp.log(nf / max_exact) / math.log(MAX_DISTANCE / max_exact)
                         * (N_BUCKETS - max_exact)).astype(jnp.int32)
    large = jnp.minimum(large, N_BUCKETS - 1)
    return jnp.where(n < max_exact, n, large)


def stick_breaking_attention(q, k, v):
    s_len = q.shape[2]
    scale = HEAD_DIM ** -0.5
    outs = []
    for i in range(s_len // Q_BLOCK):
        q0 = i * Q_BLOCK
        kl = q0 + Q_BLOCK
        qb = q[:, :, q0:kl].astype(jnp.float32)
        kp = k[:, :, :kl].astype(jnp.float32)
        vp = v[:, :, :kl].astype(jnp.float32)
        z = jnp.einsum('bhtd,bhsd->bhts', qb, kp) * scale
        t_pos = q0 + jnp.arange(Q_BLOCK)[:, None]
        s_pos = jnp.arange(kl)[None, :]
        past = s_pos < t_pos
        log_1m = jnp.where(past, jax.nn.log_sigmoid(-z), 0.0)
        log_stick = lax.cumsum(log_1m, axis=3, reverse=True) - log_1m
        w = jnp.where(past, jnp.exp(jax.nn.log_sigmoid(z) + log_stick), 0.0)
        outs.append(jnp.einsum('bhts,bhsd->bhtd', w, vp))
    return jnp.concatenate(outs, axis=2)


def moba_attention(q, k, v, rel_bias):
    b, h, s_len, d = q.shape
    scale = HEAD_DIM ** -0.5
    nb = -(-s_len // MOBA_BLOCK)
    pad = nb * MOBA_BLOCK - s_len
    kp = jnp.pad(k, ((0, 0), (0, 0), (0, pad), (0, 0)))
    vp = jnp.pad(v, ((0, 0), (0, 0), (0, pad), (0, 0)))
    kb = kp.reshape(b, h, nb, MOBA_BLOCK, d)
    vb = vp.reshape(b, h, nb, MOBA_BLOCK, d)
    k_mean = jnp.mean(kb.astype(jnp.float32), axis=3)
    pos = jnp.arange(s_len)
    q_blk = pos // MOBA_BLOCK
    gate = jnp.einsum('bhsd,bhnd->bhsn', q.astype(jnp.float32), k_mean)
    fully_past = jnp.arange(nb)[None, :] < q_blk[:, None]
    gate = jnp.where(fully_past, gate, NEG_INF)
    n_sel = min(MOBA_TOPK, nb)
    _, sel = lax.top_k(gate, n_sel)
    sel_valid = sel < q_blk[:, None]
    rel_h = rel_bias.T.astype(jnp.float32)
    head_ids = jnp.arange(h)[None, :, None, None]
    offs = jnp.arange(MOBA_BLOCK)
    gather_blocks = jax.vmap(jax.vmap(lambda blocks, ids: blocks[ids]))

    def query_block(i):
        q0 = i * Q_BLOCK
        qc = lax.dynamic_slice_in_dim(q, q0, Q_BLOCK, axis=2).astype(jnp.float32)
        sc = lax.dynamic_slice_in_dim(sel, q0, Q_BLOCK, axis=2)
        vc = lax.dynamic_slice_in_dim(sel_valid, q0, Q_BLOCK, axis=2)
        t_pos = q0 + jnp.arange(Q_BLOCK)
        logits = []
        for r in range(n_sel):
            idx = sc[..., r]
            k_sel = gather_blocks(kb, idx).astype(jnp.float32)
            k_pos = idx[..., None] * MOBA_BLOCK + offs
            bias = rel_h[head_ids, t5_bucket(t_pos[:, None] - k_pos)]
            lr = jnp.einsum('bhtd,bhtld->bhtl', qc, k_sel) * scale + bias
            logits.append(jnp.where(vc[..., r, None], lr, NEG_INF))
        own_start = (q0 // MOBA_BLOCK) * MOBA_BLOCK
        k_own = lax.dynamic_slice_in_dim(kp, own_start, MOBA_BLOCK, axis=2).astype(jnp.float32)
        v_own = lax.dynamic_slice_in_dim(vp, own_start, MOBA_BLOCK, axis=2).astype(jnp.float32)
        dist = t_pos[:, None] - (own_start + offs)[None, :]
        lo = jnp.einsum('bhtd,bhld->bhtl', qc, k_own) * scale + rel_h[:, t5_bucket(dist)]
        logits.append(jnp.where(dist >= 0, lo, NEG_INF))
        p = jax.nn.softmax(jnp.concatenate(logits, axis=-1), axis=-1)
        out = jnp.einsum('bhtl,bhld->bhtd', p[..., n_sel * MOBA_BLOCK:], v_own)
        for r in range(n_sel):
            v_sel = gather_blocks(vb, sc[..., r]).astype(jnp.float32)
            out = out + jnp.einsum('bhtl,bhtld->bhtd',
                                   p[..., r * MOBA_BLOCK:(r + 1) * MOBA_BLOCK], v_sel)
        return out

    outs = lax.map(query_block, jnp.arange(s_len // Q_BLOCK))
    return outs.transpose(1, 2, 0, 3, 4).reshape(b, h, s_len, d)


def hybrid_layer(x, mod, w_in, sb_gain, mb_gain, w_out, ln1_g, ln1_b,
                 w_gate, w_up, w_down, ln2_g, ln2_b, rel_bias):
    shift_a, scale_a, gate_a, shift_f, scale_f, gate_f = jnp.split(mod[:, None, :], 6, axis=-1)
    u = x * (1 + scale_a) + shift_a
    proj = u @ w_in
    q_sb, k_sb, v_sb, q_mb, k_mb, v_mb = jnp.split(
        proj, [D_SB, 2 * D_SB, 3 * D_SB, 3 * D_SB + D_MB, 3 * D_SB + 2 * D_MB], axis=-1)
    o_sb = stick_breaking_attention(split_heads(q_sb, N_HEADS_SB), split_heads(k_sb, N_HEADS_SB),
                                    split_heads(v_sb, N_HEADS_SB))
    o_mb = moba_attention(split_heads(q_mb, N_HEADS_MB), split_heads(k_mb, N_HEADS_MB),
                          split_heads(v_mb, N_HEADS_MB), rel_bias)
    o = jnp.concatenate([head_rms_merge(o_sb, sb_gain), head_rms_merge(o_mb, mb_gain)],
                        axis=-1).astype(x.dtype)
    x = layer_norm(DN_ALPHA * x + gate_a * (o @ w_out), ln1_g, ln1_b)
    u = x * (1 + scale_f) + shift_f
    f = (jax.nn.silu(u @ w_gate) * (u @ w_up)) @ w_down
    return layer_norm(DN_ALPHA * x + gate_f * f, ln2_g, ln2_b)


def setup_inputs(seed: int = 0) -> dict:
    key = jax.random.key(seed)
    ks = jax.random.split(key, 16)
    f32 = jnp.float32
    n = lambda k, shp: jax.random.normal(k, shp, f32)
    return {
        'x': n(ks[0], (BATCH, SEQ, D_MODEL)),
        'c': n(ks[1], (BATCH, D_MODEL)),
        'w_ada': n(ks[2], (DEPTH, D_MODEL, 6 * D_MODEL)) * D_MODEL ** -0.5,
        'b_ada': 0.02 * n(ks[3], (DEPTH, 6 * D_MODEL)),
        'w_in': n(ks[4], (DEPTH, D_MODEL, 3 * D_MIX)) * D_MODEL ** -0.5,
        'sb_gain': 1.0 + 0.02 * n(ks[5], (DEPTH, D_SB)),
        'mb_gain': 1.0 + 0.02 * n(ks[6], (DEPTH, D_MB)),
        'w_out': n(ks[7], (DEPTH, D_MIX, D_MODEL)) * (D_MIX ** -0.5 * DN_BETA),
        'ln1_g': 1.0 + 0.02 * n(ks[8], (DEPTH, D_MODEL)),
        'ln1_b': 0.02 * n(ks[9], (DEPTH, D_MODEL)),
        'w_gate': n(ks[10], (DEPTH, D_MODEL, D_FF)) * D_MODEL ** -0.5,
        'w_up': n(ks[11], (DEPTH, D_MODEL, D_FF)) * D_MODEL ** -0.5,
        'w_down': n(ks[12], (DEPTH, D_FF, D_MODEL)) * (D_FF ** -0.5 * DN_BETA),
        'ln2_g': 1.0 + 0.02 * n(ks[13], (DEPTH, D_MODEL)),
        'ln2_b': 0.02 * n(ks[14], (DEPTH, D_MODEL)),
        'rel_bias': 0.5 * n(ks[15], (N_BUCKETS, N_HEADS_MB)),
    }


def reference(x, c, w_ada, b_ada, w_in, sb_gain, mb_gain, w_out, ln1_g, ln1_b,
              w_gate, w_up, w_down, ln2_g, ln2_b, rel_bias):
    cond = jax.nn.silu(c)
    for l in range(DEPTH):
        mod = cond @ w_ada[l] + b_ada[l]
        x = hybrid_layer(x, mod, w_in[l], sb_gain[l], mb_gain[l], w_out[l], ln1_g[l], ln1_b[l],
                         w_gate[l], w_up[l], w_down[l], ln2_g[l], ln2_b[l], rel_bias)
    return x
```

```cpp
#include <hip/hip_runtime.h>
#include <cstdio>
#include <cstdint>
namespace pg8 {
#define PG8_LAS __attribute__((address_space(3)))
typedef unsigned short bf16_t;
typedef short bf16x8 __attribute__((ext_vector_type(8)));
typedef float f32x4 __attribute__((ext_vector_type(4)));
typedef unsigned u32x4 __attribute__((ext_vector_type(4)));
constexpr int BM = 256, BK = 64, HALF = 128, HTB = HALF * BK * 2  , STAGE_BYTES = 8 * HTB, NXCD = 8, WGM = 8;

__host__ __device__ __forceinline__ int lds_byte(int r, int c) { const int st = (r >> 4) * 2 + (c >> 5), rr = r & 15, cc = c & 31, ob = rr * 64 + cc * 2; return st * 1024 + (ob ^ (((ob >> 9) & 1) << 5)); }
__host__ __device__ __forceinline__ void stage_rc(int b, int& R, int& C) { const int st = b / 1024, sb = b % 1024, swz = sb ^ (((sb >> 9) & 1) << 5); R = (st >> 1) * 16 + swz / 64; C = (st & 1) * 32 + (swz % 64) / 2; }
__host__ __device__ __forceinline__ int perm32(int rho) { const int n = rho >> 4, i = rho & 15; return 8 * (i >> 2) + 4 * n + (i & 3); }

struct Unit { int pm, pn; };
struct Gemm { const bf16_t* A; const bf16_t* Bt; int M, N, K; };

struct StaticOrder {
    int nM, nN, nwg, G, c;
    __host__ __device__ void init(int M, int N, int G_, int c_) { nM = M / BM; nN = N / BM; nwg = nM * nN; G = G_; c = c_; }
    __host__ __device__ bool next(int i, Unit& u) const {
        const long L = (long)i * G + c; if (L >= nwg) return false;
        int wgid = (int)L; { const int q = nwg / NXCD, r = nwg % NXCD, xcd = wgid % NXCD, off = wgid / NXCD; wgid = (xcd < r ? xcd * (q + 1) : r * (q + 1) + (xcd - r) * q) + off; }
        const int nig = WGM * nN, gid = wgid / nig, fm = gid * WGM, gsz = (nM - fm) < WGM ? (nM - fm) : WGM;
        u.pm = fm + ((wgid % nig) % gsz); u.pn = (wgid % nig) / gsz; return true;
    }
    __device__ __forceinline__ void a_ready(const Unit&) const {}
    __device__ __forceinline__ void done(const Unit&) const {}
};

__device__ __forceinline__ unsigned cvt_pk_bf16(float lo, float hi) { unsigned r; asm volatile("v_cvt_pk_bf16_f32 %0, %1, %2" : "=v"(r) : "v"(lo), "v"(hi)); return r; }
typedef float f32x2 __attribute__((ext_vector_type(2)));
__device__ __forceinline__ f32x2 gelu_pk(f32x2 v) {
    const f32x2 av = __builtin_elementwise_abs(v), d = av * 0.2316418882f + 1.0f;
    f32x2 t; t.x = __builtin_amdgcn_rcpf(d.x); t.y = __builtin_amdgcn_rcpf(d.y);
    f32x2 q = t * 0.5307027145f + (-0.7265760135f); q = q * t + 0.7107068705f; q = q * t + (-0.142248368f); q = q * t + 0.127414796f; q = q * t;
    const f32x2 s = (v * v) * (-0.72134752044f);
    f32x2 e; e.x = __builtin_amdgcn_exp2f(s.x); e.y = __builtin_amdgcn_exp2f(s.y);
    const f32x2 m = v * (q * e), r = v - m;
    f32x2 o; o.x = v.x < 0.f ? m.x : r.x; o.y = v.y < 0.f ? m.y : r.y; return o;
}

template <int ACT  > struct EpiBf16 {
    static constexpr bool PERM = true, AFTER_DRAIN = false; static_assert(ACT == 0 || ACT == 1, "EpiBf16: ACT is 0 (none) or 1 (gelu_pk)");
    bf16_t* O; int ldc; const float* bias; int split_cols; size_t split_stride; float scale0;
    __device__ __forceinline__ void operator()(const f32x4 (&acc)[2][2][4][2], const Unit& u, int wr, int wc, int fr, int fq) const {
        const int row0 = u.pm * BM + wr * 64 + fr; int colt = u.pn * BM; bf16_t* base = O;
        float sc = 1.f; if (split_cols) { const int t = colt / split_cols; base += (size_t)t * split_stride; colt -= t * split_cols; if (t == 0) sc = scale0; }
        const int col0 = colt + wc * 32 + 8 * fq, bcol0 = u.pn * BM + wc * 32 + 8 * fq;
        f32x4 bv[2][2];
#pragma unroll
        for (int bj = 0; bj < 2; ++bj)
#pragma unroll
            for (int n = 0; n < 2; ++n) bv[bj][n] = bias ? *(const f32x4*)(bias + bcol0 + bj * HALF + 4 * n) : (f32x4){0.f, 0.f, 0.f, 0.f};
#pragma unroll
        for (int ai = 0; ai < 2; ++ai)
#pragma unroll
            for (int m = 0; m < 4; ++m) { bf16_t* rowp = base + (size_t)(row0 + ai * HALF + m * 16) * ldc + col0;
#pragma unroll
                for (int bj = 0; bj < 2; ++bj) { f32x4 v0 = acc[ai][bj][m][0] + bv[bj][0], v1 = acc[ai][bj][m][1] + bv[bj][1];
                    if (ACT == 1) { f32x2 a = gelu_pk((f32x2){v0[0], v0[1]}), b = gelu_pk((f32x2){v0[2], v0[3]}), c = gelu_pk((f32x2){v1[0], v1[1]}), d = gelu_pk((f32x2){v1[2], v1[3]});
                        v0 = (f32x4){a.x, a.y, b.x, b.y}; v1 = (f32x4){c.x, c.y, d.x, d.y}; }
                    v0 = v0 * sc; v1 = v1 * sc; u32x4 w; w.x = cvt_pk_bf16(v0[0], v0[1]); w.y = cvt_pk_bf16(v0[2], v0[3]); w.z = cvt_pk_bf16(v1[0], v1[1]); w.w = cvt_pk_bf16(v1[2], v1[3]);
                    *(u32x4*)(rowp + bj * HALF) = w; } }
    }
};

struct PanelStats {
    unsigned* xbuf;
    unsigned* cnt;
    unsigned* tmo;
    int ntn; float eps;
    unsigned code;
    __device__ __forceinline__ bool run(const f32x4 (&v)[2][2][4][2], const Unit& u, int wr, int wc, int fr, int fq, PG8_LAS unsigned char* lds, int wid, int lane) const {
        typedef float f32x2v __attribute__((ext_vector_type(2)));
        PG8_LAS f32x2v* P = (PG8_LAS f32x2v*)lds;
        PG8_LAS f32x2v* S = (PG8_LAS f32x2v*)(lds + 8192);
        PG8_LAS unsigned* flag = (PG8_LAS unsigned*)(lds + 8192 + 2048);
#pragma unroll
        for (int ai = 0; ai < 2; ++ai)
#pragma unroll
            for (int m = 0; m < 4; ++m) {
                float s = 0.f;
#pragma unroll
                for (int bj = 0; bj < 2; ++bj)
#pragma unroll
                    for (int n = 0; n < 2; ++n) { const f32x4 x = v[ai][bj][m][n]; s += (x[0] + x[1]) + (x[2] + x[3]); }
                s += __shfl_xor(s, 16); s += __shfl_xor(s, 32);
                const float mw = s * (1.0f / 64.0f); float q = 0.f;
#pragma unroll
                for (int bj = 0; bj < 2; ++bj)
#pragma unroll
                    for (int n = 0; n < 2; ++n) { const f32x4 d = v[ai][bj][m][n] - mw; q += (d[0] * d[0] + d[1] * d[1]) + (d[2] * d[2] + d[3] * d[3]); }
                q += __shfl_xor(q, 16); q += __shfl_xor(q, 32);
                if (fq == 0) P[(ai * HALF + wr * 64 + m * 16 + fr) * 4 + wc] = (f32x2v){mw, q};
            }
        asm volatile("s_waitcnt lgkmcnt(0)" ::: "memory"); __builtin_amdgcn_s_barrier(); asm volatile("" ::: "memory");
#if defined(BROKEN_EXCHANGE_NO_WAIT)
#warning BROKEN CONTROL BUILD: the row-statistics exchange does not wait; results are wrong by design
        if (blockIdx.x >= 64) { const long long t0_ = clock64(); while (clock64() - t0_ < 60000) __builtin_amdgcn_s_sleep(8); }
#endif
        const int row = wid * 32 + (lane & 31);
        if (lane < 32) {
            const f32x2v a = P[row * 4 + 0], b = P[row * 4 + 1], c = P[row * 4 + 2], d = P[row * 4 + 3];
            const float mt = (a.x + b.x + c.x + d.x) * 0.25f;
            const float da = a.x - mt, db = b.x - mt, dc = c.x - mt, dd = d.x - mt;
            const float m2 = (a.y + b.y) + (c.y + d.y) + 64.0f * ((da * da + db * db) + (dc * dc + dd * dd));
            unsigned long long* slot = (unsigned long long*)xbuf + ((size_t)(u.pm * BM + row) * 4 + u.pn);
            __hip_atomic_store(slot, ((unsigned long long)__float_as_uint(m2) << 32) | __float_as_uint(mt), __ATOMIC_RELAXED, __HIP_MEMORY_SCOPE_AGENT);
        }
        asm volatile("s_waitcnt vmcnt(0)" ::: "memory");
        if (lane == 0) __hip_atomic_fetch_add(cnt + 64 * u.pm, 1u, __ATOMIC_RELAXED, __HIP_MEMORY_SCOPE_AGENT);
        if (wid == 0) {
            bool dead = false; const unsigned long long t0 = __builtin_amdgcn_s_memrealtime(); const unsigned want = 8u * (unsigned)ntn;
            for (;;) {
#if defined(BROKEN_EXCHANGE_NO_WAIT)
                break;
#endif
                if ((unsigned)__builtin_amdgcn_readfirstlane(__hip_atomic_load(cnt + 64 * u.pm, __ATOMIC_RELAXED, __HIP_MEMORY_SCOPE_AGENT)) >= want) break;
                if (__builtin_amdgcn_s_memrealtime() - t0 > 2000000ull) {
                    if (lane == 0) { unsigned expect = 0u; __hip_atomic_compare_exchange_strong(tmo + 1, &expect, code | (unsigned)(u.pm & 0xff), __ATOMIC_RELAXED, __ATOMIC_RELAXED, __HIP_MEMORY_SCOPE_AGENT);
                                     __hip_atomic_store(tmo, 1u, __ATOMIC_RELAXED, __HIP_MEMORY_SCOPE_AGENT); }
                    dead = true; break; }
                __builtin_amdgcn_s_sleep(2);
            }
            __builtin_amdgcn_fence(__ATOMIC_ACQUIRE, "agent");
            if (lane == 0) flag[0] = dead ? 1u : 0u;
        }
        asm volatile("s_waitcnt vmcnt(0) lgkmcnt(0)" ::: "memory"); __builtin_amdgcn_s_barrier(); asm volatile("" ::: "memory");
        const bool bad = flag[0] != 0u;
        if (lane < 32) {
            const unsigned long long* slot = (const unsigned long long*)xbuf + (size_t)(u.pm * BM + row) * 4; float mt[4], m2[4]; float ms = 0.f;
#pragma unroll
            for (int t = 0; t < 4; ++t) { if (t < ntn) { const unsigned long long w = __hip_atomic_load(slot + t, __ATOMIC_RELAXED, __HIP_MEMORY_SCOPE_AGENT); mt[t] = __uint_as_float((unsigned)w); m2[t] = __uint_as_float((unsigned)(w >> 32)); } else { mt[t] = 0.f; m2[t] = 0.f; } ms += mt[t]; }
            const float mean = ms / (float)ntn; float q = 0.f;
#pragma unroll
            for (int t = 0; t < 4; ++t) if (t < ntn) { const float dm = mt[t] - mean; q += m2[t] + 256.0f * dm * dm; }
            S[row] = (f32x2v){mean, 1.0f / sqrtf(q / (256.0f * (float)ntn) + eps)};
        }
        asm volatile("s_waitcnt lgkmcnt(0)" ::: "memory"); __builtin_amdgcn_s_barrier(); asm volatile("" ::: "memory");
        return bad;
    }
};
struct EpiLnRes {
    static constexpr bool PERM = false, AFTER_DRAIN = true;
    const float* base; float* out; int ldc; const float* bias; PanelStats st; unsigned poison;
    __device__ __forceinline__ void fused(f32x4 (&acc)[2][2][4][2], const Unit& u, int wr, int wc, int fr, int fq, PG8_LAS unsigned char* lds, int wid, int lane) const {
        typedef float f32x2v __attribute__((ext_vector_type(2)));
        const PG8_LAS f32x2v* S = (const PG8_LAS f32x2v*)(lds + 8192);
        const int col0 = u.pn * BM + wc * 32 + 4 * fq;
#pragma unroll
        for (int bj = 0; bj < 2; ++bj)
#pragma unroll
            for (int n = 0; n < 2; ++n) { const f32x4 bv = bias ? *(const f32x4*)(bias + col0 + bj * HALF + n * 16) : (f32x4){0.f, 0.f, 0.f, 0.f};
#pragma unroll
                for (int ai = 0; ai < 2; ++ai)
#pragma unroll
                    for (int m = 0; m < 4; ++m) acc[ai][bj][m][n] += bv; }
        f32x4 pre[4][2][2];
#pragma unroll
        for (int m = 0; m < 4; ++m) { const size_t off = (size_t)(u.pm * BM + wr * 64 + m * 16 + fr) * ldc + col0;
#pragma unroll
            for (int bj = 0; bj < 2; ++bj)
#pragma unroll
                for (int n = 0; n < 2; ++n) pre[m][bj][n] = *(const f32x4*)(base + off + bj * HALF + n * 16); }
        const bool bad = st.run(acc, u, wr, wc, fr, fq, lds, wid, lane) || poison != 0u;
        const float qnan = __builtin_nanf("");
#pragma unroll
        for (int ai = 0; ai < 2; ++ai)
#pragma unroll
            for (int m = 0; m < 4; ++m) { const int r = ai * HALF + wr * 64 + m * 16 + fr; const f32x2v sr = S[r]; const size_t off = (size_t)(u.pm * BM + r) * ldc + col0;
#pragma unroll
                for (int bj = 0; bj < 2; ++bj)
#pragma unroll
                    for (int n = 0; n < 2; ++n) { const f32x4 bs = ai == 0 ? pre[m][bj][n] : *(const f32x4*)(base + off + bj * HALF + n * 16); f32x4 o = bs + (acc[ai][bj][m][n] - sr.x) * sr.y;
                        if (bad) o = (f32x4){qnan, qnan, qnan, qnan}; *(f32x4*)(out + off + bj * HALF + n * 16) = o; }
                if (m & 1) asm volatile("" ::: "memory"); }
    }
};
struct EpiLnResLn {
    static constexpr bool PERM = false, AFTER_DRAIN = true;
    const float* base; float* out; bf16_t* xn; int ldc; const float* bias; PanelStats st1, st2; unsigned poison;
    __device__ __forceinline__ void fused(f32x4 (&acc)[2][2][4][2], const Unit& u, int wr, int wc, int fr, int fq, PG8_LAS unsigned char* lds, int wid, int lane) const {
        typedef float f32x2v __attribute__((ext_vector_type(2))); typedef unsigned u32x2v __attribute__((ext_vector_type(2)));
        const PG8_LAS f32x2v* S = (const PG8_LAS f32x2v*)(lds + 8192);
        const int col0 = u.pn * BM + wc * 32 + 4 * fq;
#pragma unroll
        for (int bj = 0; bj < 2; ++bj)
#pragma unroll
            for (int n = 0; n < 2; ++n) { const f32x4 bv = bias ? *(const f32x4*)(bias + col0 + bj * HALF + n * 16) : (f32x4){0.f, 0.f, 0.f, 0.f};
#pragma unroll
                for (int ai = 0; ai < 2; ++ai)
#pragma unroll
                    for (int m = 0; m < 4; ++m) acc[ai][bj][m][n] += bv; }
        bool bad = st1.run(acc, u, wr, wc, fr, fq, lds, wid, lane) || poison != 0u;
        const float qnan = __builtin_nanf("");
#pragma unroll
        for (int ai = 0; ai < 2; ++ai)
#pragma unroll
            for (int m = 0; m < 4; ++m) { const int r = ai * HALF + wr * 64 + m * 16 + fr; const f32x2v sr = S[r]; const size_t off = (size_t)(u.pm * BM + r) * ldc + col0;
#pragma unroll
                for (int bj = 0; bj < 2; ++bj)
#pragma unroll
                    for (int n = 0; n < 2; ++n) { const f32x4 bs = *(const f32x4*)(base + off + bj * HALF + n * 16); acc[ai][bj][m][n] = bs + (acc[ai][bj][m][n] - sr.x) * sr.y; }
                asm volatile("" : "+v"(acc[ai][0][m][0]), "+v"(acc[ai][0][m][1]), "+v"(acc[ai][1][m][0]), "+v"(acc[ai][1][m][1]));
                if (m & 1) asm volatile("" ::: "memory"); }
        const bool bad1 = bad;
        bad = st2.run(acc, u, wr, wc, fr, fq, lds, wid, lane) || bad;
#pragma unroll
        for (int ai = 0; ai < 2; ++ai)
#pragma unroll
            for (int m = 0; m < 4; ++m) { const int r = ai * HALF + wr * 64 + m * 16 + fr; const f32x2v sr = S[r]; const size_t off = (size_t)(u.pm * BM + r) * ldc + col0;
#pragma unroll
                for (int bj = 0; bj < 2; ++bj)
#pragma unroll
                    for (int n = 0; n < 2; ++n) { const f32x4 x1 = acc[ai][bj][m][n]; *(f32x4*)(out + off + bj * HALF + n * 16) = bad1 ? (f32x4){qnan, qnan, qnan, qnan} : x1;
                        const f32x4 o = (x1 - sr.x) * sr.y; u32x2v w; w.x = cvt_pk_bf16(o[0], o[1]); w.y = cvt_pk_bf16(o[2], o[3]);
                        if (bad) { w.x = 0x7fc07fc0u; w.y = 0x7fc07fc0u; } *(u32x2v*)(xn + off + bj * HALF + n * 16) = w; }
                asm volatile("" ::: "memory"); }
    }
};

template <class Epi, class Sched, bool ALIGN_EPI = false, bool SP2 = false>
__device__ __forceinline__ void gemm_phase(PG8_LAS unsigned char* lds, const Gemm g, const Sched& S, const Epi& E) {
    const int tid = threadIdx.x, wid = __builtin_amdgcn_readfirstlane(tid >> 6), lane = tid & 63, wr = wid >> 2, wc = wid & 3, fr = lane & 15, fq = lane >> 4;
    const int K = g.K, nt = K / BK;
    unsigned voffA[2], voffB[2];
#pragma unroll
    for (int i = 0; i < 2; ++i) { int R, C; stage_rc(tid * 16 + i * 8192, R, C); const int Rb = Epi::PERM ? ((R & ~31) + perm32(R & 31)) : R;
        voffA[i] = (unsigned)(R * K + C) * 2u; voffB[i] = (unsigned)(Rb * K + C) * 2u; }
    const size_t kstep = (size_t)(BK * 2);
    const size_t hstep = (size_t)HALF * K * 2;
    const size_t tstep = 2 * hstep;
    const unsigned ldsw = (unsigned)wid * 1024u;
    const int aoff = lds_byte(wr * 64 + fr, fq * 8), boff = lds_byte(wc * 32 + fr, fq * 8);
#define PG8_SA(b, h) (((b) * 2 + (h)) * HTB)
#define PG8_SB(b, h) ((4 + (b) * 2 + (h)) * HTB)
#define PG8_STAGE(bufoff, gbase, voff) do { _Pragma("unroll") for (int _i = 0; _i < 2; ++_i) \
        __builtin_amdgcn_global_load_lds((const unsigned*)((const char*)(gbase) + (voff)[_i]), (PG8_LAS unsigned*)(lds + (bufoff) + ldsw + _i * 8192), 16, 0, 0); } while (0)
#define PG8_LDA(dst, b, h) do { _Pragma("unroll") for (int m = 0; m < 4; ++m) _Pragma("unroll") for (int k = 0; k < 2; ++k) dst[m][k] = *(const PG8_LAS bf16x8*)(lds + PG8_SA(b, h) + aoff + m * 2048 + k * 1024); } while (0)
#define PG8_LDB(dst, b, h) do { _Pragma("unroll") for (int n = 0; n < 2; ++n) _Pragma("unroll") for (int k = 0; k < 2; ++k) dst[n][k] = *(const PG8_LAS bf16x8*)(lds + PG8_SB(b, h) + boff + n * 2048 + k * 1024); } while (0)
#define PG8_MMA(ai, bj, At, Bt) do { __builtin_amdgcn_s_setprio(1); _Pragma("unroll") for (int m = 0; m < 4; ++m) _Pragma("unroll") for (int n = 0; n < 2; ++n) _Pragma("unroll") for (int k = 0; k < 2; ++k) \
        acc[ai][bj][m][n] = __builtin_amdgcn_mfma_f32_16x16x32_bf16(Bt[n][k], At[m][k], acc[ai][bj][m][n], 0, 0, 0); __builtin_amdgcn_s_setprio(0); } while (0)
#define PG8_WAIT_V(n) asm volatile("s_waitcnt vmcnt(" #n ")" ::: "memory")
#define PG8_WAIT_L(n) asm volatile("s_waitcnt lgkmcnt(" #n ")" ::: "memory")
#define PG8_BAR __builtin_amdgcn_s_barrier()
#define PG8_SCHED __builtin_amdgcn_sched_barrier(0)
    Unit cur, nxt; int ui = 0;
    if (!S.next(0, cur)) return;
    f32x4 acc[2][2][4][2];
#pragma unroll
    for (int a = 0; a < 2; ++a)
#pragma unroll
        for (int b = 0; b < 2; ++b)
#pragma unroll
            for (int m = 0; m < 4; ++m)
#pragma unroll
                for (int n = 0; n < 2; ++n) acc[a][b][m][n] = (f32x4){0.f, 0.f, 0.f, 0.f};
    bf16x8 At[4][2], B0[2][2], B1[2][2];
    const char* cA = (const char*)g.A + (size_t)cur.pm * tstep; const char* cB = (const char*)g.Bt + (size_t)cur.pn * tstep;
    S.a_ready(cur);
    if constexpr (SP2) {
        PG8_STAGE(PG8_SB(0, 0), cB, voffB); PG8_STAGE(PG8_SB(0, 1), cB + hstep, voffB); PG8_STAGE(PG8_SA(0, 0), cA, voffA); PG8_STAGE(PG8_SA(0, 1), cA + hstep, voffA);
        if (wr == 1) PG8_BAR;
        PG8_WAIT_V(2); PG8_BAR;
        PG8_STAGE(PG8_SB(1, 0), cB + kstep, voffB); PG8_STAGE(PG8_SA(1, 0), cA + kstep, voffA); PG8_STAGE(PG8_SB(1, 1), cB + hstep + kstep, voffB);
        PG8_WAIT_V(6); PG8_BAR;
    } else {
        PG8_STAGE(PG8_SB(0, 0), cB, voffB); PG8_STAGE(PG8_SA(0, 0), cA, voffA); PG8_STAGE(PG8_SB(0, 1), cB + hstep, voffB); PG8_STAGE(PG8_SA(0, 1), cA + hstep, voffA);
        if (wr == 1) PG8_BAR;
        PG8_WAIT_V(4); PG8_BAR;
        PG8_STAGE(PG8_SB(1, 0), cB + kstep, voffB); PG8_STAGE(PG8_SA(1, 0), cA + kstep, voffA); PG8_STAGE(PG8_SB(1, 1), cB + hstep + kstep, voffB);
        PG8_WAIT_V(6); PG8_BAR;
    }
    for (;;) {
        const bool has_next = S.next(ui + 1, nxt);
        const char* nA = has_next ? (const char*)g.A + (size_t)nxt.pm * tstep : cA; const char* nB = has_next ? (const char*)g.Bt + (size_t)nxt.pn * tstep : cB;
        for (int t = 0; t < nt; t += 2) {
            const bool last = (t == nt - 2);
            const char* a1 = cA + (size_t)(t + 1) * kstep;
            const char* a2 = last ? nA : cA + (size_t)(t + 2) * kstep; const char* b2 = last ? nB : cB + (size_t)(t + 2) * kstep;
            const char* a3 = a2 + kstep; const char* b3 = b2 + kstep;
            if (last && has_next) S.a_ready(nxt);
            if constexpr (SP2) {
            PG8_LDB(B0, 0, 0); PG8_LDB(B1, 0, 1); PG8_SCHED; PG8_LDA(At, 0, 0); PG8_STAGE(PG8_SA(1, 1), a1 + hstep, voffA);
            PG8_WAIT_V(8); PG8_WAIT_L(0); PG8_BAR; PG8_MMA(0, 0, At, B0); PG8_MMA(0, 1, At, B1); PG8_BAR; PG8_SCHED;
            PG8_LDA(At, 0, 1); PG8_STAGE(PG8_SB(0, 0), b2, voffB); PG8_STAGE(PG8_SB(0, 1), b2 + hstep, voffB); PG8_STAGE(PG8_SA(0, 0), a2, voffA);
            PG8_WAIT_V(8); PG8_WAIT_L(0); PG8_BAR; PG8_MMA(1, 0, At, B0); PG8_MMA(1, 1, At, B1); PG8_BAR; PG8_SCHED;
            PG8_LDB(B0, 1, 0); PG8_LDB(B1, 1, 1); PG8_SCHED; PG8_LDA(At, 1, 0); PG8_STAGE(PG8_SA(0, 1), a2 + hstep, voffA);
            PG8_WAIT_V(8); PG8_WAIT_L(0); PG8_BAR; PG8_MMA(0, 0, At, B0); PG8_MMA(0, 1, At, B1); PG8_BAR; PG8_SCHED;
            PG8_LDA(At, 1, 1); PG8_STAGE(PG8_SB(1, 0), b3, voffB); PG8_STAGE(PG8_SB(1, 1), b3 + hstep, voffB); PG8_STAGE(PG8_SA(1, 0), a3, voffA);
            PG8_WAIT_V(8); PG8_WAIT_L(0); PG8_BAR; PG8_MMA(1, 0, At, B0); PG8_MMA(1, 1, At, B1); PG8_BAR; PG8_SCHED;
            } else {
            PG8_LDB(B0, 0, 0); PG8_SCHED; PG8_LDA(At, 0, 0); PG8_STAGE(PG8_SA(1, 1), a1 + hstep, voffA);
            PG8_WAIT_L(8); PG8_BAR; PG8_WAIT_L(0); PG8_MMA(0, 0, At, B0); PG8_BAR; PG8_SCHED;
            PG8_LDB(B1, 0, 1); PG8_STAGE(PG8_SB(0, 0), b2, voffB);
            PG8_BAR; PG8_WAIT_L(0); PG8_MMA(0, 1, At, B1); PG8_BAR;
            PG8_LDA(At, 0, 1); PG8_STAGE(PG8_SA(0, 0), a2, voffA);
            PG8_BAR; PG8_WAIT_L(0); PG8_MMA(1, 0, At, B0); PG8_BAR; PG8_SCHED;
            PG8_STAGE(PG8_SB(0, 1), b2 + hstep, voffB);
            PG8_WAIT_V(6); PG8_BAR; PG8_MMA(1, 1, At, B1); PG8_BAR;
            PG8_LDB(B0, 1, 0); PG8_SCHED; PG8_LDA(At, 1, 0); PG8_STAGE(PG8_SA(0, 1), a2 + hstep, voffA);
            PG8_WAIT_L(8); PG8_BAR; PG8_WAIT_L(0); PG8_MMA(0, 0, At, B0); PG8_BAR; PG8_SCHED;
            PG8_LDB(B1, 1, 1); PG8_STAGE(PG8_SB(1, 0), b3, voffB);
            PG8_BAR; PG8_WAIT_L(0); PG8_MMA(0, 1, At, B1); PG8_BAR;
            PG8_LDA(At, 1, 1); PG8_STAGE(PG8_SA(1, 0), a3, voffA);
            PG8_BAR; PG8_WAIT_L(0); PG8_MMA(1, 0, At, B0); PG8_BAR; PG8_SCHED;
            PG8_STAGE(PG8_SB(1, 1), b3 + hstep, voffB);
            PG8_WAIT_V(6); PG8_BAR; PG8_MMA(1, 1, At, B1); PG8_BAR;
            }
        }
        if constexpr (ALIGN_EPI) { if (wr == 0) PG8_BAR; }
        if constexpr (!Epi::AFTER_DRAIN) { E(acc, cur, wr, wc, fr, fq); S.done(cur); }
        if (!has_next) break;
#pragma unroll
        for (int a = 0; a < 2; ++a)
#pragma unroll
            for (int b = 0; b < 2; ++b)
#pragma unroll
                for (int m = 0; m < 4; ++m)
#pragma unroll
                    for (int n = 0; n < 2; ++n) acc[a][b][m][n] = (f32x4){0.f, 0.f, 0.f, 0.f};
        cur = nxt; cA = nA; cB = nB; ++ui;
        if constexpr (ALIGN_EPI) { if (wr == 1) PG8_BAR; }
    }
    PG8_WAIT_V(0);
    if constexpr (!ALIGN_EPI) { if (wr == 0) PG8_BAR; }
    PG8_BAR;
    if constexpr (Epi::AFTER_DRAIN) { E.fused(acc, cur, wr, wc, fr, fq, lds, wid, lane); S.done(cur); }
#undef PG8_SA
#undef PG8_SB
#undef PG8_STAGE
#undef PG8_LDA
#undef PG8_LDB
#undef PG8_MMA
#undef PG8_WAIT_V
#undef PG8_WAIT_L
#undef PG8_BAR
#undef PG8_SCHED
}
}

constexpr int BATCH = 4, SEQ = 4096, D = 1024, M = BATCH * SEQ, HD = 64, NH = 8, DFF = 2816, NQKV = 3072, NBLK = 16, MB_BLOCK = 256;
constexpr float LN_EPS = 1e-5f, RMS_EPS = 1e-6f, DN_ALPHA = 1.189207115002721f, LOG2E = 1.4426950408889634f, C2 = 0.125f * 1.4426950408889634f;
constexpr float SB_EXIT = 152.0f;
constexpr size_t MiB = 1u << 20;
constexpr size_t WS_CTL = 0, CTL_ZERO_BYTES = 1 * MiB;
constexpr size_t WS_MOD = 1 * MiB, WS_LUT = 1 * MiB + 128 * 1024, WS_CST = 1 * MiB + 256 * 1024, WS_XBAR = 1 * MiB + 512 * 1024;
constexpr size_t WS_GP = 2 * MiB, WS_WIN = 4 * MiB, WS_WOUT = 10 * MiB, WS_WGU = 12 * MiB, WS_WDN = 23 * MiB, WS_XCH = 29 * MiB;
constexpr size_t WS_U = 32 * MiB, WS_KS = 64 * MiB, WS_VT = 96 * MiB, WS_QO = 128 * MiB, WS_H = 128 * MiB, WS_GATE = 160 * MiB, WS_TMP = 64 * MiB, WS_END = 216 * MiB;
typedef unsigned short bf16;
typedef float f32x4 __attribute__((ext_vector_type(4)));
typedef unsigned u32x4 __attribute__((ext_vector_type(4)));

__device__ __forceinline__ unsigned f2bf(float f) { unsigned u = __builtin_bit_cast(unsigned, f); return (u + 0x7fffu + ((u >> 16) & 1u)) >> 16; }
__device__ __forceinline__ float bf2f(unsigned short b) { return __builtin_bit_cast(float, (unsigned)b << 16); }
__device__ __forceinline__ float silu_f(float g) { return g * __builtin_amdgcn_rcpf(1.0f + __builtin_amdgcn_exp2f(-g * LOG2E)); }
__device__ __forceinline__ float wave_sum(float v) {
#pragma unroll
    for (int o = 1; o < 64; o <<= 1) v += __shfl_xor(v, o);
    return v;
}
__device__ __forceinline__ int t5_bucket(int n) {
    if (n < 16) return n;
    int b = 16;
    b += (n >= 19) + (n >= 21) + (n >= 24) + (n >= 27) + (n >= 31) + (n >= 35) + (n >= 40) + (n >= 46) + (n >= 52) + (n >= 59) + (n >= 67) + (n >= 77) + (n >= 87) + (n >= 99) + (n >= 113);
    return b;
}

namespace pg8 {
struct EpiQKV {
    static constexpr bool PERM = true, AFTER_DRAIN = false;
    bf16_t* Qs; bf16_t* Ks; bf16_t* Vt;
    __device__ __forceinline__ void operator()(const f32x4 (&acc)[2][2][4][2], const Unit& u, int wr, int wc, int fr, int fq) const {
        const int row0 = u.pm * BM + wr * 64 + fr; const int colt = u.pn * BM;
        if (colt < 2048) {
            bf16_t* base = colt < 1024 ? Qs : Ks; const float sc = colt < 1024 ? C2 : 1.0f; const int col0 = (colt & 1023) + wc * 32 + 8 * fq;
#pragma unroll
            for (int ai = 0; ai < 2; ++ai)
#pragma unroll
                for (int m = 0; m < 4; ++m) { bf16_t* rowp = base + (size_t)(row0 + ai * HALF + m * 16) * 1024 + col0;
#pragma unroll
                    for (int bj = 0; bj < 2; ++bj) { f32x4 v0 = acc[ai][bj][m][0] * sc, v1 = acc[ai][bj][m][1] * sc;
                        u32x4 w; w.x = cvt_pk_bf16(v0[0], v0[1]); w.y = cvt_pk_bf16(v0[2], v0[3]); w.z = cvt_pk_bf16(v1[0], v1[1]); w.w = cvt_pk_bf16(v1[2], v1[3]);
                        *(u32x4*)(rowp + bj * HALF) = w; } }
        } else {
            const int c0 = (colt - 2048) + wc * 32 + 8 * fq;
#pragma unroll
            for (int ai = 0; ai < 2; ++ai)
#pragma unroll
                for (int m = 0; m < 4; ++m) { const int r = row0 + ai * HALF + m * 16; const int b = r >> 12, t = r & 4095;
#pragma unroll
                    for (int bj = 0; bj < 2; ++bj) { const int c = c0 + bj * HALF; bf16_t* p = Vt + ((size_t)(b * 16 + (c >> 6)) * 64 + (c & 63)) * 4096 + t;
                        const f32x4 v0 = acc[ai][bj][m][0], v1 = acc[ai][bj][m][1];
                        const unsigned w0 = cvt_pk_bf16(v0[0], v0[1]), w1 = cvt_pk_bf16(v0[2], v0[3]), w2 = cvt_pk_bf16(v1[0], v1[1]), w3 = cvt_pk_bf16(v1[2], v1[3]);
                        p[0 * 4096] = (bf16_t)(w0 & 0xffffu); p[1 * 4096] = (bf16_t)(w0 >> 16); p[2 * 4096] = (bf16_t)(w1 & 0xffffu); p[3 * 4096] = (bf16_t)(w1 >> 16);
                        p[4 * 4096] = (bf16_t)(w2 & 0xffffu); p[5 * 4096] = (bf16_t)(w2 >> 16); p[6 * 4096] = (bf16_t)(w3 & 0xffffu); p[7 * 4096] = (bf16_t)(w3 >> 16); } }
        }
    }
};
struct EpiSwiGLU {
    static constexpr bool PERM = true, AFTER_DRAIN = false;
    bf16_t* H;
    __device__ __forceinline__ void operator()(const f32x4 (&acc)[2][2][4][2], const Unit& u, int wr, int wc, int fr, int fq) const {
        const int row0 = u.pm * BM + wr * 64 + fr; const int col0 = u.pn * HALF + wc * 32 + 8 * fq;
#pragma unroll
        for (int ai = 0; ai < 2; ++ai)
#pragma unroll
            for (int m = 0; m < 4; ++m) { bf16_t* rowp = H + (size_t)(row0 + ai * HALF + m * 16) * DFF + col0;
                f32x4 h0, h1;
#pragma unroll
                for (int j = 0; j < 4; ++j) { h0[j] = silu_f(acc[ai][0][m][0][j]) * acc[ai][1][m][0][j]; h1[j] = silu_f(acc[ai][0][m][1][j]) * acc[ai][1][m][1][j]; }
                u32x4 w; w.x = cvt_pk_bf16(h0[0], h0[1]); w.y = cvt_pk_bf16(h0[2], h0[3]); w.z = cvt_pk_bf16(h1[0], h1[1]); w.w = cvt_pk_bf16(h1[2], h1[3]);
                *(u32x4*)rowp = w; }
    }
};
struct EpiF32 {
    static constexpr bool PERM = false, AFTER_DRAIN = false;
    float* C; int ldc;
    __device__ __forceinline__ void operator()(const f32x4 (&acc)[2][2][4][2], const Unit& u, int wr, int wc, int fr, int fq) const {
        const int row0 = u.pm * BM + wr * 64 + fr, col0 = u.pn * BM + wc * 32 + 4 * fq;
#pragma unroll
        for (int ai = 0; ai < 2; ++ai)
#pragma unroll
            for (int m = 0; m < 4; ++m) { float* rowp = C + (size_t)(row0 + ai * HALF + m * 16) * ldc + col0;
#pragma unroll
                for (int bj = 0; bj < 2; ++bj)
#pragma unroll
                    for (int n = 0; n < 2; ++n) *(f32x4*)(rowp + bj * HALF + n * 16) = acc[ai][bj][m][n]; }
    }
};
}

constexpr int LDS_BYTES = 147456;

__global__ void __launch_bounds__(256) k_mod(const float* c, const float* w_ada, const float* b_ada, float* mod) {
    const int j = blockIdx.x * 256 + threadIdx.x;
    float a0 = 0.f, a1 = 0.f, a2 = 0.f, a3 = 0.f;
    for (int k = 0; k < D; ++k) { const float w = w_ada[(size_t)k * 6144 + j];
        a0 += silu_f(c[k]) * w; a1 += silu_f(c[D + k]) * w; a2 += silu_f(c[2 * D + k]) * w; a3 += silu_f(c[3 * D + k]) * w; }
    const float bb = b_ada[j];
    mod[j] = a0 + bb; mod[6144 + j] = a1 + bb; mod[2 * 6144 + j] = a2 + bb; mod[3 * 6144 + j] = a3 + bb;
}
__global__ void k_lut(const float* rel_bias, float* lut) {
    const int i = blockIdx.x * blockDim.x + threadIdx.x; if (i >= 8 * 128) return;
    const int h = i >> 7, d = i & 127; lut[i] = rel_bias[t5_bucket(d) * 8 + h] * LOG2E;
}
__device__ __forceinline__ int map_win(int c) { const int g = c >> 9, o = c & 511; return (g == 0 ? 0 : g == 1 ? 1024 : g == 2 ? 2048 : g == 3 ? 512 : g == 4 ? 1536 : 2560) + o; }
__global__ void __launch_bounds__(256) k_transpose(const float* W, int K, int N, bf16* Wt, int mode) {
    __shared__ float tile[32][33];
    const int k0 = blockIdx.y * 32, n0 = blockIdx.x * 32, tx = threadIdx.x & 31, ty = threadIdx.x >> 5;
    for (int i = ty; i < 32; i += 8) tile[i][tx] = W[(size_t)(k0 + i) * N + n0 + tx];
    __syncthreads();
    for (int i = ty; i < 32; i += 8) { const int n = n0 + i; int r = n;
        if (mode == 1) r = map_win(n); else if (mode == 2) r = (n >> 7) * 256 + (n & 127); else if (mode == 3) r = (n >> 7) * 256 + 128 + (n & 127);
        Wt[(size_t)r * K + k0 + tx] = (bf16)f2bf(tile[tx][i]); }
}
__global__ void __launch_bounds__(256) k_xbar(const float* x, float* xbar) {
    const int blk = blockIdx.y, k = blockIdx.x * 256 + threadIdx.x; float s = 0.f;
    for (int r = 0; r < 256; ++r) s += x[((size_t)blk * 256 + r) * D + k];
    xbar[blk * D + k] = s * (1.0f / 256.0f);
}
__global__ void __launch_bounds__(256) k_modulate(const float* x, const float* mod, int soff, bf16* U) {
    const size_t i = ((size_t)blockIdx.x * 256 + threadIdx.x) * 4; const int row = (int)(i >> 10), k = (int)(i & 1023), b = row >> 12;
    const f32x4 v = *(const f32x4*)(x + i), sh = *(const f32x4*)(mod + b * 6144 + soff + k), sc = *(const f32x4*)(mod + b * 6144 + soff + 1024 + k);
    const f32x4 u = v * (1.0f + sc) + sh;
    uint2 o; o.x = f2bf(u[0]) | (f2bf(u[1]) << 16); o.y = f2bf(u[2]) | (f2bf(u[3]) << 16); *(uint2*)(U + i) = o;
}
__global__ void __launch_bounds__(512) k_gvec(const float* xbar, const float* mod, const float* w_in, float* Gp, float* cst) {
    __shared__ float ub[1024]; __shared__ float km[512];
    const int blk = blockIdx.x, b = blk >> 4, n = blk & 15, tid = threadIdx.x;
    for (int k = tid; k < 1024; k += 512) ub[k] = xbar[blk * D + k] * (1.0f + mod[b * 6144 + 1024 + k]) + mod[b * 6144 + k];
    __syncthreads();
    { float s = 0.f; for (int k = 0; k < 1024; ++k) s += ub[k] * w_in[(size_t)k * NQKV + 2048 + tid]; km[tid] = s; }
    __syncthreads();
    { const int h = tid >> 6, kl = tid & 63; float cs = 0.f;
#pragma unroll 1
        for (int i = 0; i < 16; ++i) { const int k = kl + 64 * i; const float* wr = w_in + (size_t)k * NQKV + 1536 + h * 64; float s = 0.f;
#pragma unroll 8
            for (int d = 0; d < 64; ++d) s += wr[d] * km[h * 64 + d];
            Gp[((size_t)b * 128 + h * 16 + n) * D + k] = (1.0f + mod[b * 6144 + 1024 + k]) * s; cs += mod[b * 6144 + k] * s; }
        cs = wave_sum(cs); if (kl == 0) cst[b * 128 + h * 16 + n] = cs; }
}
__global__ void __launch_bounds__(128) k_gate(const float* x, const float* Gp, const float* cst, float* gate) {
    const int t = blockIdx.x, col = threadIdx.x, b = t >> 12; const float* xr = x + (size_t)t * D; const float* g = Gp + ((size_t)b * 128 + col) * D;
    float s0 = 0.f, s1 = 0.f, s2 = 0.f, s3 = 0.f;
    for (int k = 0; k < D; k += 4) { const f32x4 a = *(const f32x4*)(xr + k), w = *(const f32x4*)(g + k); s0 += a[0] * w[0]; s1 += a[1] * w[1]; s2 += a[2] * w[2]; s3 += a[3] * w[3]; }
    gate[(size_t)t * 128 + col] = cst[b * 128 + col] + ((s0 + s1) + (s2 + s3));
}
template <class Epi> __global__ void __launch_bounds__(512, 2) k_gemm(pg8::Gemm g, Epi E) {
    extern __shared__ __attribute__((aligned(16))) unsigned char lds[];
    pg8::StaticOrder S; S.init(g.M, g.N, gridDim.x, blockIdx.x);
    pg8::gemm_phase<Epi, pg8::StaticOrder, true, true>((PG8_LAS unsigned char*)lds, g, S, E);
}
__global__ void __launch_bounds__(64) k_attn_sb(const bf16* Qs, const bf16* Ks, const bf16* Vt, const float* gain, bf16* O) {
    const int idx = blockIdx.x * 64 + threadIdx.x; const int t = idx & 4095, h = (idx >> 12) & 7, b = idx >> 15; const int row = b * 4096 + t;
    float q[64], o[64];
#pragma unroll
    for (int d = 0; d < 64; ++d) { q[d] = bf2f(Qs[(size_t)row * 1024 + h * 64 + d]); o[d] = 0.f; }
    float cum = 0.f; const bf16* vb = Vt + (size_t)(b * 16 + h) * 64 * 4096;
    for (int s = t - 1; s >= 0; --s) {
        const bf16* kr = Ks + (size_t)(b * 4096 + s) * 1024 + h * 64; float z = 0.f;
#pragma unroll
        for (int d = 0; d < 64; ++d) z += q[d] * bf2f(kr[d]);
        const float l = __builtin_amdgcn_logf(1.0f + __builtin_amdgcn_exp2f(-fabsf(z)));
        const float sp = fmaxf(z, 0.f) + l, ls = fminf(z, 0.f) - l;
        const float w = __builtin_amdgcn_exp2f(ls - cum);
#pragma unroll
        for (int d = 0; d < 64; ++d) o[d] += w * bf2f(vb[(size_t)d * 4096 + s]);
        cum += sp;
        if (cum >= SB_EXIT) break;
    }
    float ss = 0.f;
#pragma unroll
    for (int d = 0; d < 64; ++d) ss += o[d] * o[d];
    const float r = 1.0f / sqrtf(ss * (1.0f / 64.0f) + RMS_EPS);
#pragma unroll
    for (int d = 0; d < 64; ++d) O[(size_t)row * 1024 + h * 64 + d] = (bf16)f2bf(o[d] * r * gain[h * 64 + d]);
}
__global__ void __launch_bounds__(64) k_attn_mb(const bf16* Qs, const bf16* Ks, const bf16* Vt, const float* gate, const float* lut, const float* gain, bf16* O) {
    const int idx = blockIdx.x * 64 + threadIdx.x; const int t = idx & 4095, h = (idx >> 12) & 7, b = idx >> 15; const int row = b * 4096 + t, j = t >> 8;
    float q[64], o[64];
#pragma unroll
    for (int d = 0; d < 64; ++d) { q[d] = bf2f(Qs[(size_t)row * 1024 + 512 + h * 64 + d]); o[d] = 0.f; }
    unsigned selmask = 0u;
    for (int r = 0; r < 3 && r < j; ++r) { float best = -INFINITY; int bi = -1;
        for (int n = 0; n < j; ++n) { const float g = gate[(size_t)row * 128 + h * 16 + n]; if (!((selmask >> n) & 1u) && g > best) { best = g; bi = n; } }
        if (bi >= 0) selmask |= 1u << bi; }
    selmask |= 1u << j;
    float m = -INFINITY, l = 0.f; const bf16* vb = Vt + (size_t)(b * 16 + 8 + h) * 64 * 4096; const float* lh = lut + h * 128;
    for (int n = 0; n <= j; ++n) { if (!((selmask >> n) & 1u)) continue;
        const int s_end = (n == j) ? t : n * 256 + 255;
        for (int s = n * 256; s <= s_end; ++s) {
            const bf16* kr = Ks + (size_t)(b * 4096 + s) * 1024 + 512 + h * 64; float z = 0.f;
#pragma unroll
            for (int d = 0; d < 64; ++d) z += q[d] * bf2f(kr[d]);
            const int dist = t - s; z += lh[dist < 127 ? dist : 127];
            const float mn = fmaxf(m, z), f = __builtin_amdgcn_exp2f(m - mn), p = __builtin_amdgcn_exp2f(z - mn);
            l = l * f + p;
#pragma unroll
            for (int d = 0; d < 64; ++d) o[d] = o[d] * f + p * bf2f(vb[(size_t)d * 4096 + s]);
            m = mn; } }
    const float il = 1.0f / l; float ss = 0.f;
#pragma unroll
    for (int d = 0; d < 64; ++d) { o[d] *= il; ss += o[d] * o[d]; }
    const float r = 1.0f / sqrtf(ss * (1.0f / 64.0f) + RMS_EPS);
#pragma unroll
    for (int d = 0; d < 64; ++d) O[(size_t)row * 1024 + 512 + h * 64 + d] = (bf16)f2bf(o[d] * r * gain[h * 64 + d]);
}
__global__ void __launch_bounds__(256) k_ln(const float* base, const float* tmp, const float* mod, int goff, const float* lg, const float* lb, float* out, bf16* U2, int soff) {
    const int row = blockIdx.x * 4 + (threadIdx.x >> 6), lane = threadIdx.x & 63, b = row >> 12; const float* md = mod + b * 6144;
    f32x4 y[4]; float s = 0.f;
#pragma unroll
    for (int j = 0; j < 4; ++j) { const int k = 256 * j + 4 * lane; const f32x4 xb = *(const f32x4*)(base + (size_t)row * D + k), tv = *(const f32x4*)(tmp + (size_t)row * D + k), gt = *(const f32x4*)(md + goff + k);
        y[j] = xb * DN_ALPHA + gt * tv; s += (y[j][0] + y[j][1]) + (y[j][2] + y[j][3]); }
    const float mean = wave_sum(s) * (1.0f / D); float s2 = 0.f;
#pragma unroll
    for (int j = 0; j < 4; ++j) { y[j] = y[j] - mean; s2 += (y[j][0] * y[j][0] + y[j][1] * y[j][1]) + (y[j][2] * y[j][2] + y[j][3] * y[j][3]); }
    const float rstd = 1.0f / sqrtf(wave_sum(s2) * (1.0f / D) + LN_EPS);
#pragma unroll
    for (int j = 0; j < 4; ++j) { const int k = 256 * j + 4 * lane; const f32x4 gg = *(const f32x4*)(lg + k), bb = *(const f32x4*)(lb + k); const f32x4 o = y[j] * rstd * gg + bb;
        *(f32x4*)(out + (size_t)row * D + k) = o;
        if (U2) { const f32x4 sh = *(const f32x4*)(md + soff + k), sc = *(const f32x4*)(md + soff + 1024 + k); const f32x4 u = o * (1.0f + sc) + sh;
            uint2 w; w.x = f2bf(u[0]) | (f2bf(u[1]) << 16); w.y = f2bf(u[2]) | (f2bf(u[3]) << 16); *(uint2*)(U2 + (size_t)row * D + k) = w; } }
}

extern "C" void kernel_launch(void* const* d_in, const int* in_sizes, int n_in, void* d_out, int out_size, void* d_ws, size_t ws_size, hipStream_t stream) {
    static int ok = 0;
    if (ok == 0) {
        if (n_in != 16 || in_sizes[0] != M * D || out_size != M * D || ws_size < WS_END) { fprintf(stderr, "kernel_launch: unexpected shapes (n_in %d, in0 %d, out %d, ws %zu)\n", n_in, n_in > 0 ? in_sizes[0] : -1, out_size, ws_size); ok = -1; return; }
        (void)hipFuncSetAttribute((const void*)k_gemm<pg8::EpiQKV>, hipFuncAttributeMaxDynamicSharedMemorySize, LDS_BYTES);
        (void)hipFuncSetAttribute((const void*)k_gemm<pg8::EpiSwiGLU>, hipFuncAttributeMaxDynamicSharedMemorySize, LDS_BYTES);
        (void)hipFuncSetAttribute((const void*)k_gemm<pg8::EpiF32>, hipFuncAttributeMaxDynamicSharedMemorySize, LDS_BYTES);
        ok = 1;
    }
    if (ok < 0) return;
    const float* x = (const float*)d_in[0]; const float* c = (const float*)d_in[1]; const float* w_ada = (const float*)d_in[2]; const float* b_ada = (const float*)d_in[3];
    const float* w_in = (const float*)d_in[4]; const float* sb_gain = (const float*)d_in[5]; const float* mb_gain = (const float*)d_in[6]; const float* w_out = (const float*)d_in[7];
    const float* ln1_g = (const float*)d_in[8]; const float* ln1_b = (const float*)d_in[9]; const float* w_gate = (const float*)d_in[10]; const float* w_up = (const float*)d_in[11];
    const float* w_down = (const float*)d_in[12]; const float* ln2_g = (const float*)d_in[13]; const float* ln2_b = (const float*)d_in[14]; const float* rel_bias = (const float*)d_in[15];
    unsigned char* ws = (unsigned char*)d_ws; float* out = (float*)d_out;
    float* mod = (float*)(ws + WS_MOD); float* lut = (float*)(ws + WS_LUT); float* cst = (float*)(ws + WS_CST); float* xbar = (float*)(ws + WS_XBAR); float* Gp = (float*)(ws + WS_GP);
    bf16* Win = (bf16*)(ws + WS_WIN); bf16* Wout = (bf16*)(ws + WS_WOUT); bf16* Wgu = (bf16*)(ws + WS_WGU); bf16* Wdn = (bf16*)(ws + WS_WDN);
    bf16* U = (bf16*)(ws + WS_U); bf16* Ks = (bf16*)(ws + WS_KS); bf16* Vt = (bf16*)(ws + WS_VT); bf16* QO = (bf16*)(ws + WS_QO); bf16* H = (bf16*)(ws + WS_H);
    float* gate = (float*)(ws + WS_GATE); float* tmp = (float*)(ws + WS_TMP);
    k_mod<<<6144 / 256, 256, 0, stream>>>(c, w_ada, b_ada, mod);
    k_lut<<<4, 256, 0, stream>>>(rel_bias, lut);
    k_transpose<<<dim3(NQKV / 32, D / 32), 256, 0, stream>>>(w_in, D, NQKV, Win, 1);
    k_transpose<<<dim3(D / 32, D / 32), 256, 0, stream>>>(w_out, D, D, Wout, 0);
    k_transpose<<<dim3(DFF / 32, D / 32), 256, 0, stream>>>(w_gate, D, DFF, Wgu, 2);
    k_transpose<<<dim3(DFF / 32, D / 32), 256, 0, stream>>>(w_up, D, DFF, Wgu, 3);
    k_transpose<<<dim3(D / 32, DFF / 32), 256, 0, stream>>>(w_down, DFF, D, Wdn, 0);
    k_xbar<<<dim3(D / 256, 64), 256, 0, stream>>>(x, xbar);
    k_modulate<<<M * D / 1024, 256, 0, stream>>>(x, mod, 0, U);
    k_gvec<<<64, 512, 0, stream>>>(xbar, mod, w_in, Gp, cst);
    k_gate<<<M, 128, 0, stream>>>(x, Gp, cst, gate);
    { pg8::Gemm g{U, Win, M, NQKV, D}; pg8::EpiQKV E{QO, Ks, Vt}; k_gemm<pg8::EpiQKV><<<256, 512, LDS_BYTES, stream>>>(g, E); }
    k_attn_sb<<<M * NH / 64, 64, 0, stream>>>(QO, Ks, Vt, sb_gain, QO);
    k_attn_mb<<<M * NH / 64, 64, 0, stream>>>(QO, Ks, Vt, gate, lut, mb_gain, QO);
    { pg8::Gemm g{QO, Wout, M, D, D}; pg8::EpiF32 E{tmp, D}; k_gemm<pg8::EpiF32><<<256, 512, LDS_BYTES, stream>>>(g, E); }
    k_ln<<<M / 4, 256, 0, stream>>>(x, tmp, mod, 2048, ln1_g, ln1_b, out, U, 3072);
    { pg8::Gemm g{U, Wgu, M, 2 * DFF, D}; pg8::EpiSwiGLU E{H}; k_gemm<pg8::EpiSwiGLU><<<256, 512, LDS_BYTES, stream>>>(g, E); }
    { pg8::Gemm g{H, Wdn, M, D, DFF}; pg8::EpiF32 E{tmp, D}; k_gemm<pg8::EpiF32><<<256, 512, LDS_BYTES, stream>>>(g, E); }
    k_ln<<<M / 4, 256, 0, stream>>>(out, tmp, mod, 5120, ln2_g, ln2_b, out, nullptr, 0);
}
```
